# Optimizing an MI355X kernel written in HIP

```python
import math
import jax, jax.numpy as jnp
from jax import lax
import numpy as np

D_MODEL = 1024
BATCH = 8
SEQ = 2048
DEPTH = 1

N_MEM = 256
RMS_EPS = 1e-6
RG_HEADS = 8
RG_HEAD_DIM = 64
RG_W = RG_HEADS * RG_HEAD_DIM
CONV_WIDTH = 4
LRU_C = 8.0
DA_HEADS = 4
DA_HEAD_DIM = 64
DA_V_DIM = 2 * DA_HEAD_DIM
DA_W = DA_HEADS * DA_V_DIM
LAYER_INDEX = 1
LAMBDA_INIT = 0.8 - 0.6 * math.exp(-0.3 * (LAYER_INDEX - 1))
Q_BLOCK = 128
XA_HEADS = 4
XA_HEAD_DIM = 128
XA_W = XA_HEADS * XA_HEAD_DIM
D_MIX = RG_W + DA_W + XA_W
IN_SPLITS = [RG_W, RG_W,
             DA_HEADS * 2 * DA_HEAD_DIM, DA_HEADS * 2 * DA_HEAD_DIM,
             DA_W, DA_W,
             XA_W, XA_W]
D_IN = sum(IN_SPLITS)

kernel_name = "hymba_style_rglru_diffattn_memxattn_layer"


def rms_norm(x, g, eps=RMS_EPS):
    xf = x.astype(jnp.float32)
    y = xf * lax.rsqrt(jnp.mean(xf * xf, axis=-1, keepdims=True) + eps)
    return (y * g.astype(jnp.float32)).astype(x.dtype)


def causal_depthwise_conv(x, w, b):
    s = x.shape[1]
    xp = jnp.pad(x, ((0, 0), (CONV_WIDTH - 1, 0), (0, 0)))
    y = b
    for k in range(CONV_WIDTH):
        y = y + w[k] * xp[:, k:k + s]
    return y


def rg_lru(xc, w_rg_a, b_rg_a, w_rg_x, b_rg_x, lru_lambda):
    b_, s, _ = xc.shape
    xh = xc.reshape(b_, s, RG_HEADS, RG_HEAD_DIM)
    r = jax.nn.sigmoid(jnp.einsum('bshi,hij->bshj', xh, w_rg_a)
                       + b_rg_a.reshape(RG_HEADS, RG_HEAD_DIM))
    i = jax.nn.sigmoid(jnp.einsum('bshi,hij->bshj', xh, w_rg_x)
                       + b_rg_x.reshape(RG_HEADS, RG_HEAD_DIM))
    r = r.reshape(b_, s, RG_W).astype(jnp.float32)
    i = i.reshape(b_, s, RG_W).astype(jnp.float32)
    log_a = -LRU_C * r * jax.nn.softplus(-lru_lambda.astype(jnp.float32))
    a = jnp.exp(log_a)
    mult = jnp.sqrt(jnp.maximum(1.0 - jnp.exp(2.0 * log_a), 0.0))
    u = mult * (i * xc.astype(jnp.float32))

    def combine(c1, c2):
        a1, b1 = c1
        a2, b2 = c2
        return a1 * a2, a2 * b1 + b2

    _, h = lax.associative_scan(combine, (a, u), axis=1)
    return h.astype(xc.dtype)


def diff_attention(q, k, v, lam):
    s = q.shape[1]
    scale = DA_HEAD_DIM ** -0.5
    q1, q2 = q[..., 0, :], q[..., 1, :]
    k1, k2 = k[..., 0, :], k[..., 1, :]
    outs = []
    for blk in range(s // Q_BLOCK):
        q0, kend = blk * Q_BLOCK, (blk + 1) * Q_BLOCK
        mask = (q0 + jnp.arange(Q_BLOCK))[:, None] >= jnp.arange(kend)[None, :]
        s1 = jnp.einsum('bqhd,bkhd->bhqk', q1[:, q0:kend], k1[:, :kend]).astype(jnp.float32) * scale
        s2 = jnp.einsum('bqhd,bkhd->bhqk', q2[:, q0:kend], k2[:, :kend]).astype(jnp.float32) * scale
        p1 = jax.nn.softmax(jnp.where(mask, s1, -jnp.inf), axis=-1)
        p2 = jax.nn.softmax(jnp.where(mask, s2, -jnp.inf), axis=-1)
        p = (p1 - lam * p2).astype(v.dtype)
        outs.append(jnp.einsum('bhqk,bkhe->bqhe', p, v[:, :kend]))
    return jnp.concatenate(outs, axis=1)


def mem_cross_attention(q, km, vm):
    sc = jnp.einsum('bshd,bmhd->bhsm', q, km).astype(jnp.float32) * (XA_HEAD_DIM ** -0.5)
    p = jax.nn.softmax(sc, axis=-1).astype(vm.dtype)
    return jnp.einsum('bhsm,bmhd->bshd', p, vm)


def setup_inputs(seed: int = 0) -> dict:
    key = jax.random.key(seed)
    ks = jax.random.split(key, 24)
    f32 = jnp.float32
    nrm = lambda k, shp, sc: jax.random.normal(k, shp, f32) * sc
    a0 = jax.random.uniform(ks[10], (RG_W,), f32, 0.9, 0.999)
    base = a0 ** (1.0 / LRU_C)
    lru_lambda = jnp.log(base / (1.0 - base))
    return {
        "x": nrm(ks[0], (BATCH, SEQ, D_MODEL), 1.0),
        "mem": nrm(ks[1], (BATCH, N_MEM, D_MODEL), 1.0),
        "g_pre": 1.0 + nrm(ks[2], (D_MODEL,), 0.02),
        "g_mem": 1.0 + nrm(ks[3], (D_MODEL,), 0.02),
        "w_in": nrm(ks[4], (D_MODEL, D_IN), D_MODEL ** -0.5),
        "w_mem_kv": nrm(ks[5], (D_MODEL, 2 * XA_W), D_MODEL ** -0.5),
        "conv_w": nrm(ks[6], (CONV_WIDTH, RG_W), CONV_WIDTH ** -0.5),
        "conv_b": nrm(ks[7], (RG_W,), 0.01),
        "w_rg_a": nrm(ks[8], (RG_HEADS, RG_HEAD_DIM, RG_HEAD_DIM), RG_HEAD_DIM ** -0.5),
        "b_rg_a": nrm(ks[9], (RG_W,), 0.01),
        "w_rg_x": nrm(ks[11], (RG_HEADS, RG_HEAD_DIM, RG_HEAD_DIM), RG_HEAD_DIM ** -0.5),
        "b_rg_x": nrm(ks[12], (RG_W,), 0.01),
        "lru_lambda": lru_lambda,
        "lambda_q1": nrm(ks[13], (DA_HEAD_DIM,), 0.1),
        "lambda_k1": nrm(ks[14], (DA_HEAD_DIM,), 0.1),
        "lambda_q2": nrm(ks[15], (DA_HEAD_DIM,), 0.1),
        "lambda_k2": nrm(ks[16], (DA_HEAD_DIM,), 0.1),
        "g_subln": 1.0 + nrm(ks[17], (DA_V_DIM,), 0.02),
        "w_out": nrm(ks[18], (D_MIX, D_MODEL), D_MIX ** -0.5),
        "g_post": 1.0 + nrm(ks[19], (D_MODEL,), 0.02),
    }


def reference(x, mem, g_pre, g_mem, w_in, w_mem_kv, conv_w, conv_b, w_rg_a, b_rg_a,
              w_rg_x, b_rg_x, lru_lambda, lambda_q1, lambda_k1, lambda_q2, lambda_k2,
              g_subln, w_out, g_post):
    b_, s, _ = x.shape
    memn = rms_norm(mem, g_mem)
    km, vm = jnp.split(memn @ w_mem_kv, 2, axis=-1)
    km = km.reshape(b_, N_MEM, XA_HEADS, XA_HEAD_DIM)
    vm = vm.reshape(b_, N_MEM, XA_HEADS, XA_HEAD_DIM)
    lam = (jnp.exp(jnp.sum(lambda_q1.astype(jnp.float32) * lambda_k1.astype(jnp.float32)))
           - jnp.exp(jnp.sum(lambda_q2.astype(jnp.float32) * lambda_k2.astype(jnp.float32)))
           + LAMBDA_INIT)

    for _ in range(DEPTH):
        hn = rms_norm(x, g_pre)
        proj = hn @ w_in
        cuts = np.cumsum(IN_SPLITS)[:-1].tolist()
        rg_x, rg_g, da_q, da_k, da_v, da_g, xa_q, xa_g = jnp.split(proj, cuts, axis=-1)

        xc = causal_depthwise_conv(rg_x, conv_w, conv_b)
        y_rg = rg_lru(xc, w_rg_a, b_rg_a, w_rg_x, b_rg_x, lru_lambda) * jax.nn.silu(rg_g)

        q = da_q.reshape(b_, s, DA_HEADS, 2, DA_HEAD_DIM)
        k = da_k.reshape(b_, s, DA_HEADS, 2, DA_HEAD_DIM)
        v = da_v.reshape(b_, s, DA_HEADS, DA_V_DIM)
        o = diff_attention(q, k, v, lam)
        o = rms_norm(o, g_subln) * (1.0 - LAMBDA_INIT)
        y_da = o.reshape(b_, s, DA_W) * jax.nn.silu(da_g)

        oc = mem_cross_attention(xa_q.reshape(b_, s, XA_HEADS, XA_HEAD_DIM), km, vm)
        y_xa = oc.reshape(b_, s, XA_W) * jax.nn.silu(xa_g)

        y = jnp.concatenate([y_rg, y_da, y_xa], axis=-1) @ w_out
        x = x + rms_norm(y, g_post)
    return x
```

```cpp
#include <hip/hip_runtime.h>
#include <cstdint>
#include <cstdio>

typedef unsigned short bf16;
__device__ __forceinline__ unsigned f2bf(float f) { unsigned u = __builtin_bit_cast(unsigned, f); return (u + 0x7fffu + ((u >> 16) & 1u)) >> 16; }
__device__ __forceinline__ float bf2f(bf16 b) { return __builtin_bit_cast(float, (unsigned)b << 16); }

constexpr int BATCH = 8, SEQ = 2048, DM = 1024, NMEM = 256, DIN = 4096, DMIX = 1536;
constexpr int M = BATCH * SEQ, MM = BATCH * NMEM;
constexpr float EPS = 1e-6f;
constexpr float LAMBDA_INIT = 0.2f;
constexpr int C_RGX = 0, C_RGG = 512, C_DAQ = 1024, C_DAK = 1536, C_DAV = 2048, C_DAG = 2560, C_XAQ = 3072, C_XAG = 3584;

constexpr size_t MiB = 1u << 20;
constexpr size_t WS_WIN = 2 * MiB, WS_WKV = 10 * MiB, WS_WOUT = 12 * MiB, WS_MN = 16 * MiB, WS_KVM = 20 * MiB,
                 WS_XN = 32 * MiB, WS_PROJ = 64 * MiB, WS_YCAT = 192 * MiB;

__global__ void __launch_bounds__(256) k_rmsnorm_rows(const float* x, const float* g, bf16* out) {
    const int row = blockIdx.x, tid = threadIdx.x;
    const float* xr = x + (size_t)row * DM;
    float v[4]; float s = 0.f;
    for (int j = 0; j < 4; ++j) { v[j] = xr[tid + 256 * j]; s += v[j] * v[j]; }
    __shared__ float red[256];
    red[tid] = s; __syncthreads();
    for (int o = 128; o > 0; o >>= 1) { if (tid < o) red[tid] += red[tid + o]; __syncthreads(); }
    const float rstd = 1.0f / sqrtf(red[0] * (1.0f / DM) + EPS);
    for (int j = 0; j < 4; ++j) out[(size_t)row * DM + tid + 256 * j] = (bf16)f2bf(v[j] * rstd * g[tid + 256 * j]);
}
__global__ void __launch_bounds__(256) k_transpose_w(const float* W, bf16* Wt, int K, int N) {
    __shared__ float t[32][33];
    const int k0 = blockIdx.y * 32, n0 = blockIdx.x * 32, tx = threadIdx.x & 31, ty = threadIdx.x >> 5;
    for (int i = ty; i < 32; i += 8) t[i][tx] = W[(size_t)(k0 + i) * N + n0 + tx];
    __syncthreads();
    for (int i = ty; i < 32; i += 8) Wt[(size_t)(n0 + i) * K + k0 + tx] = (bf16)f2bf(t[tx][i]);
}
template <bool OUTF32>
__global__ void __launch_bounds__(256) k_gemm_naive(const bf16* A, const bf16* Bt, void* Cv, int Mr, int N, int K) {
    __shared__ float As[16][65], Bs[16][65];
    const int m0 = blockIdx.y * 64, n0 = blockIdx.x * 64, tid = threadIdx.x, tx = tid & 15, ty = tid >> 4;
    float acc[4][4] = {};
    for (int k0 = 0; k0 < K; k0 += 16) {
        for (int i = tid; i < 64 * 16; i += 256) { const int r = i >> 4, c = i & 15;
            As[c][r] = bf2f(A[(size_t)(m0 + r) * K + k0 + c]); Bs[c][r] = bf2f(Bt[(size_t)(n0 + r) * K + k0 + c]); }
        __syncthreads();
        for (int kk = 0; kk < 16; ++kk) {
            float a[4], b[4];
            for (int i = 0; i < 4; ++i) { a[i] = As[kk][ty * 4 + i]; b[i] = Bs[kk][tx * 4 + i]; }
            for (int i = 0; i < 4; ++i) for (int j = 0; j < 4; ++j) acc[i][j] += a[i] * b[j];
        }
        __syncthreads();
    }
    for (int i = 0; i < 4; ++i) for (int j = 0; j < 4; ++j) {
        const size_t o = (size_t)(m0 + ty * 4 + i) * N + n0 + tx * 4 + j;
        if (OUTF32) ((float*)Cv)[o] = acc[i][j]; else ((bf16*)Cv)[o] = (bf16)f2bf(acc[i][j]);
    }
}
__device__ __forceinline__ float sigmoidf_(float x) { return 1.0f / (1.0f + expf(-x)); }
__device__ __forceinline__ float siluf_(float x) { return x / (1.0f + expf(-x)); }

__global__ void __launch_bounds__(64) k_rglru_naive(const bf16* proj, const float* conv_w, const float* conv_b, const float* w_a, const float* b_a,
                                                   const float* w_x, const float* b_x, const float* lru_lambda, bf16* ycat) {
    const int b = blockIdx.x >> 3, h = blockIdx.x & 7, j = threadIdx.x, c = h * 64 + j;
    __shared__ float xs[64];
    __shared__ float wa[64][64], wx[64][64];
    for (int i = 0; i < 64; ++i) { wa[i][j] = w_a[(size_t)h * 4096 + i * 64 + j]; wx[i][j] = w_x[(size_t)h * 4096 + i * 64 + j]; }
    const float cw0 = conv_w[0 * 512 + c], cw1 = conv_w[1 * 512 + c], cw2 = conv_w[2 * 512 + c], cw3 = conv_w[3 * 512 + c], cb = conv_b[c];
    const float ba = b_a[c], bx = b_x[c];
    const float L = lru_lambda[c];
    const float sp = (-L > 20.f) ? -L : log1pf(expf(-L));
    float x0 = 0.f, x1 = 0.f, x2 = 0.f, hst = 0.f;
    __syncthreads();
    for (int t = 0; t < SEQ; ++t) {
        const size_t row = (size_t)(b * SEQ + t) * DIN;
        const float x3 = bf2f(proj[row + C_RGX + c]);
        const float xc = cb + cw0 * x0 + cw1 * x1 + cw2 * x2 + cw3 * x3;
        x0 = x1; x1 = x2; x2 = x3;
        xs[j] = xc; __syncthreads();
        float ra = ba, ri = bx;
        for (int i = 0; i < 64; ++i) { const float xv = xs[i]; ra += xv * wa[i][j]; ri += xv * wx[i][j]; }
        __syncthreads();
        const float r = sigmoidf_(ra), ig = sigmoidf_(ri);
        const float log_a = -8.0f * r * sp;
        const float a = expf(log_a);
        const float mult = sqrtf(fmaxf(1.0f - expf(2.0f * log_a), 0.f));
        const float u = mult * (ig * xc);
        hst = a * hst + u;
        const float g = bf2f(proj[row + C_RGG + c]);
        ycat[(size_t)(b * SEQ + t) * DMIX + c] = (bf16)f2bf(hst * siluf_(g));
    }
}
__device__ __forceinline__ float wave_max(float v) { for (int o = 32; o > 0; o >>= 1) v = fmaxf(v, __shfl_xor(v, o)); return v; }
__device__ __forceinline__ float wave_sum(float v) { for (int o = 32; o > 0; o >>= 1) v += __shfl_xor(v, o); return v; }
__device__ __forceinline__ float compute_lam(const float* q1, const float* k1, const float* q2, const float* k2) {
    float s1 = 0.f, s2 = 0.f; for (int i = 0; i < 64; ++i) { s1 += q1[i] * k1[i]; s2 += q2[i] * k2[i]; }
    return expf(s1) - expf(s2) + LAMBDA_INIT;
}
__global__ void __launch_bounds__(256) k_diffattn_naive(const bf16* proj, const float* lq1, const float* lk1, const float* lq2, const float* lk2,
                                                        const float* g_subln, bf16* ycat) {
    __shared__ float s1s[4][SEQ], s2s[4][SEQ];
    const int w = threadIdx.x >> 6, lane = threadIdx.x & 63;
    const int gq = blockIdx.x * 4 + w;
    const int q = gq % SEQ, h = (gq / SEQ) % 4, b = gq / (SEQ * 4);
    const float lam = compute_lam(lq1, lk1, lq2, lk2);
    const bf16* qrow = proj + (size_t)(b * SEQ + q) * DIN + C_DAQ + h * 128;
    const int kend = (q / 128 + 1) * 128;
    float m1 = -INFINITY, m2 = -INFINITY;
    for (int k = lane; k < kend; k += 64) {
        const bf16* krow = proj + (size_t)(b * SEQ + k) * DIN + C_DAK + h * 128;
        float a1 = 0.f, a2 = 0.f;
        for (int d = 0; d < 64; ++d) { a1 += bf2f(qrow[d]) * bf2f(krow[d]); a2 += bf2f(qrow[64 + d]) * bf2f(krow[64 + d]); }
        a1 *= 0.125f; a2 *= 0.125f;
        if (k > q) { a1 = -INFINITY; a2 = -INFINITY; }
        s1s[w][k] = a1; s2s[w][k] = a2; m1 = fmaxf(m1, a1); m2 = fmaxf(m2, a2);
    }
    m1 = wave_max(m1); m2 = wave_max(m2);
    float l1 = 0.f, l2 = 0.f;
    for (int k = lane; k < kend; k += 64) { const float e1 = expf(s1s[w][k] - m1), e2 = expf(s2s[w][k] - m2); s1s[w][k] = e1; s2s[w][k] = e2; l1 += e1; l2 += e2; }
    l1 = wave_sum(l1); l2 = wave_sum(l2);
    const float i1 = 1.0f / l1, i2 = lam / l2;
    __syncthreads();
    float o0 = 0.f, o1 = 0.f;
    for (int k = 0; k <= q; ++k) {
        const float p = s1s[w][k] * i1 - s2s[w][k] * i2;
        const bf16* vrow = proj + (size_t)(b * SEQ + k) * DIN + C_DAV + h * 128;
        o0 += p * bf2f(vrow[lane]); o1 += p * bf2f(vrow[64 + lane]);
    }
    const float ms = wave_sum(o0 * o0 + o1 * o1) * (1.0f / 128.0f);
    const float rstd = 1.0f / sqrtf(ms + EPS);
    const bf16* grow = proj + (size_t)(b * SEQ + q) * DIN + C_DAG + h * 128;
    bf16* orow = ycat + (size_t)(b * SEQ + q) * DMIX + 512 + h * 128;
    orow[lane] = (bf16)f2bf(o0 * rstd * g_subln[lane] * (1.0f - LAMBDA_INIT) * siluf_(bf2f(grow[lane])));
    orow[64 + lane] = (bf16)f2bf(o1 * rstd * g_subln[64 + lane] * (1.0f - LAMBDA_INIT) * siluf_(bf2f(grow[64 + lane])));
}
__global__ void __launch_bounds__(256) k_xattn_naive(const bf16* proj, const bf16* kvm, bf16* ycat) {
    __shared__ float ss[4][NMEM];
    const int w = threadIdx.x >> 6, lane = threadIdx.x & 63;
    const int gq = blockIdx.x * 4 + w;
    const int q = gq % SEQ, h = (gq / SEQ) % 4, b = gq / (SEQ * 4);
    const bf16* qrow = proj + (size_t)(b * SEQ + q) * DIN + C_XAQ + h * 128;
    float mx = -INFINITY;
    for (int k = lane; k < NMEM; k += 64) {
        const bf16* krow = kvm + (size_t)(b * NMEM + k) * 1024 + h * 128;
        float a = 0.f; for (int d = 0; d < 128; ++d) a += bf2f(qrow[d]) * bf2f(krow[d]);
        a *= 0.08838834764831845f; ss[w][k] = a; mx = fmaxf(mx, a);
    }
    mx = wave_max(mx);
    float l = 0.f;
    for (int k = lane; k < NMEM; k += 64) { const float e = expf(ss[w][k] - mx); ss[w][k] = e; l += e; }
    l = wave_sum(l);
    __syncthreads();
    float o0 = 0.f, o1 = 0.f;
    for (int k = 0; k < NMEM; ++k) { const float p = ss[w][k]; const bf16* vrow = kvm + (size_t)(b * NMEM + k) * 1024 + 512 + h * 128; o0 += p * bf2f(vrow[lane]); o1 += p * bf2f(vrow[64 + lane]); }
    const float il = 1.0f / l;
    const bf16* grow = proj + (size_t)(b * SEQ + q) * DIN + C_XAG + h * 128;
    bf16* orow = ycat + (size_t)(b * SEQ + q) * DMIX + 1024 + h * 128;
    orow[lane] = (bf16)f2bf(o0 * il * siluf_(bf2f(grow[lane])));
    orow[64 + lane] = (bf16)f2bf(o1 * il * siluf_(bf2f(grow[64 + lane])));
}
__global__ void __launch_bounds__(256) k_post(const float* y, const float* x, const float* g, float* out) {
    const int row = blockIdx.x, tid = threadIdx.x;
    const float* yr = y + (size_t)row * DM;
    float v[4]; float s = 0.f;
    for (int j = 0; j < 4; ++j) { v[j] = yr[tid + 256 * j]; s += v[j] * v[j]; }
    __shared__ float red[256];
    red[tid] = s; __syncthreads();
    for (int o = 128; o > 0; o >>= 1) { if (tid < o) red[tid] += red[tid + o]; __syncthreads(); }
    const float rstd = 1.0f / sqrtf(red[0] * (1.0f / DM) + EPS);
    for (int j = 0; j < 4; ++j) { const size_t o = (size_t)row * DM + tid + 256 * j; out[o] = x[o] + v[j] * rstd * g[tid + 256 * j]; }
}

extern "C" void kernel_launch(void* const* d_in, const int* in_sizes, int n_in, void* d_out, int out_size, void* d_ws, size_t ws_size, hipStream_t stream) {
    const float* x = (const float*)d_in[0]; const float* mem = (const float*)d_in[1]; const float* g_pre = (const float*)d_in[2]; const float* g_mem = (const float*)d_in[3];
    const float* w_in = (const float*)d_in[4]; const float* w_mem_kv = (const float*)d_in[5]; const float* conv_w = (const float*)d_in[6]; const float* conv_b = (const float*)d_in[7];
    const float* w_rg_a = (const float*)d_in[8]; const float* b_rg_a = (const float*)d_in[9]; const float* w_rg_x = (const float*)d_in[10]; const float* b_rg_x = (const float*)d_in[11];
    const float* lru_lambda = (const float*)d_in[12]; const float* lq1 = (const float*)d_in[13]; const float* lk1 = (const float*)d_in[14]; const float* lq2 = (const float*)d_in[15];
    const float* lk2 = (const float*)d_in[16]; const float* g_subln = (const float*)d_in[17]; const float* w_out = (const float*)d_in[18]; const float* g_post = (const float*)d_in[19];
    unsigned char* ws = (unsigned char*)d_ws;
    bf16* WIN = (bf16*)(ws + WS_WIN); bf16* WKV = (bf16*)(ws + WS_WKV); bf16* WOUT = (bf16*)(ws + WS_WOUT); bf16* MN = (bf16*)(ws + WS_MN); bf16* KVM = (bf16*)(ws + WS_KVM);
    bf16* XN = (bf16*)(ws + WS_XN); bf16* PROJ = (bf16*)(ws + WS_PROJ); bf16* YCAT = (bf16*)(ws + WS_YCAT);
    float* Y = (float*)(ws + WS_PROJ);
    k_rmsnorm_rows<<<M, 256, 0, stream>>>(x, g_pre, XN);
    k_rmsnorm_rows<<<MM, 256, 0, stream>>>(mem, g_mem, MN);
    k_transpose_w<<<dim3(DIN / 32, DM / 32), 256, 0, stream>>>(w_in, WIN, DM, DIN);
    k_transpose_w<<<dim3(1024 / 32, DM / 32), 256, 0, stream>>>(w_mem_kv, WKV, DM, 1024);
    k_transpose_w<<<dim3(DM / 32, DMIX / 32), 256, 0, stream>>>(w_out, WOUT, DMIX, DM);
    k_gemm_naive<false><<<dim3(DIN / 64, M / 64), 256, 0, stream>>>(XN, WIN, PROJ, M, DIN, DM);
    k_gemm_naive<false><<<dim3(1024 / 64, MM / 64), 256, 0, stream>>>(MN, WKV, KVM, MM, 1024, DM);
    k_rglru_naive<<<BATCH * 8, 64, 0, stream>>>(PROJ, conv_w, conv_b, w_rg_a, b_rg_a, w_rg_x, b_rg_x, lru_lambda, YCAT);
    k_diffattn_naive<<<BATCH * 4 * SEQ / 4, 256, 0, stream>>>(PROJ, lq1, lk1, lq2, lk2, g_subln, YCAT);
    k_xattn_naive<<<BATCH * 4 * SEQ / 4, 256, 0, stream>>>(PROJ, KVM, YCAT);
    k_gemm_naive<true><<<dim3(DM / 64, M / 64), 256, 0, stream>>>(YCAT, WOUT, Y, M, DM, DMIX);
    k_post<<<M, 256, 0, stream>>>(Y, x, g_post, (float*)d_out);
}
```
